# Optimizing an MI355X kernel written in HIP

```python
import jax, jax.numpy as jnp
from jax import lax
import numpy as np

D_MODEL = 1024
BATCH = 8
SEQ = 2048
DEPTH = 2
DEC_BATCH = 128
DEC_SEQ = 8
PAST_LEN = 16384
PAGE_SIZE = 128

PLE_DIM = 256
W_POOL = 512
POOL_WINDOWS = (2, 4, 8, 16)
N_POOL_GROUPS = 4
POOL_GROUP = W_POOL // N_POOL_GROUPS
POOL_BUF = max(POOL_WINDOWS) - 1
W_SCONV = 512
SCONV_K = 3
W_CCONV = 512
CCONV_K = 31
D_FF = 2816
N_BRANCH = 3
IN_COLS = W_POOL + 3 * W_SCONV + 2 * W_CCONV + N_BRANCH * D_MODEL
EPS = 1e-6

kernel_name = "hybrid_pool_shortconv_conformer_decoder_step"


def rmsnorm(x, g):
    xf = x.astype(jnp.float32)
    y = xf * lax.rsqrt(jnp.mean(xf * xf, axis=-1, keepdims=True) + EPS)
    return (y * g.astype(jnp.float32)).astype(x.dtype)


def layernorm(x, g, b):
    xf = x.astype(jnp.float32)
    mu = jnp.mean(xf, axis=-1, keepdims=True)
    xc = xf - mu
    y = xc * lax.rsqrt(jnp.mean(xc * xc, axis=-1, keepdims=True) + EPS)
    return (y * g.astype(jnp.float32) + b.astype(jnp.float32)).astype(x.dtype)


def swiglu(x, wg, wu, wd):
    return (jax.nn.silu(x @ wg) * (x @ wu)) @ wd


def causal_dwconv(buf, x, w):
    xp = jnp.concatenate([buf.astype(x.dtype), x], axis=1)
    c = x.shape[-1]
    out = lax.conv_general_dilated(xp, w[:, None, :].astype(x.dtype), window_strides=(1,), padding='VALID',
                                   dimension_numbers=('NWC', 'WIO', 'NWC'), feature_group_count=c)
    k = w.shape[0]
    return out, xp[:, xp.shape[1] - (k - 1):]


def pool_mixer(buf, a, pos0, pool_w, pool_scale):
    n, l, _ = a.shape
    ap = jnp.concatenate([buf.astype(a.dtype), a], axis=1)
    cs = jnp.pad(jnp.cumsum(ap.astype(jnp.float32), axis=1), ((0, 0), (1, 0), (0, 0)))
    pos = pos0 + jnp.arange(l)
    means = []
    for gi, w in enumerate(POOL_WINDOWS):
        sl = slice(gi * POOL_GROUP, (gi + 1) * POOL_GROUP)
        s = cs[:, POOL_BUF + 1:POOL_BUF + 1 + l, sl] - cs[:, POOL_BUF + 1 - w:POOL_BUF + 1 - w + l, sl]
        cnt = jnp.minimum(w, pos + 1).astype(jnp.float32)
        means.append(s / cnt[None, :, None])
    m = (jnp.concatenate(means, axis=-1) - a.astype(jnp.float32)).astype(a.dtype)
    m = m.reshape(n, l, N_POOL_GROUPS, POOL_GROUP)
    y = jnp.einsum('blgc,gcd->blgd', m, pool_w).reshape(n, l, W_POOL)
    return y * pool_scale, ap[:, ap.shape[1] - POOL_BUF:]


def mixer(u, bpool, bsc, bcf, pos0, P, i):
    n, l, _ = u.shape
    z = u @ P['w_in'][i]
    o = 0
    a = z[..., o:o + W_POOL]; o += W_POOL
    v = z[..., o:o + W_SCONV]; o += W_SCONV
    bg = z[..., o:o + W_SCONV]; o += W_SCONV
    cg = z[..., o:o + W_SCONV]; o += W_SCONV
    ga = z[..., o:o + W_CCONV]; o += W_CCONV
    gg = z[..., o:o + W_CCONV]; o += W_CCONV
    gates = jax.nn.sigmoid(z[..., o:].reshape(n, l, N_BRANCH, D_MODEL))
    ya, nb_pool = pool_mixer(bpool, a, pos0, P['pool_w'][i], P['pool_scale'][i])
    cv, nb_sc = causal_dwconv(bsc, cg * v, P['sc_conv'][i])
    yb = bg * cv
    glu = ga * jax.nn.sigmoid(gg)
    cc, nb_cf = causal_dwconv(bcf, glu, P['cf_conv'][i])
    yc = jax.nn.silu(layernorm(cc + P['cf_conv_b'][i], P['cf_ln_g'][i], P['cf_ln_b'][i]))
    m = (gates[:, :, 0] * (ya @ P['w_pool_out'][i])
         + gates[:, :, 1] * (yb @ P['w_sc_out'][i])
         + gates[:, :, 2] * (yc @ P['w_cf_out'][i]))
    return m @ P['w_o'][i], nb_pool, nb_sc, nb_cf


def trunk(x, p, bpool, bsc, bcf, pos0, P):
    h = x
    npool, nsc, ncf = [], [], []
    for i in range(DEPTH):
        f = swiglu(rmsnorm(h, P['g_f1_pre'][i]), P['w_f1_gate'][i], P['w_f1_up'][i], P['w_f1_down'][i])
        h = h + 0.5 * rmsnorm(f, P['g_f1_post'][i])
        mo, a1, a2, a3 = mixer(rmsnorm(h, P['g_mix_pre'][i]), bpool[i], bsc[i], bcf[i], pos0, P, i)
        h = h + rmsnorm(mo, P['g_mix_post'][i])
        f = swiglu(rmsnorm(h, P['g_f2_pre'][i]), P['w_f2_gate'][i], P['w_f2_up'][i], P['w_f2_down'][i])
        h = h + 0.5 * rmsnorm(f, P['g_f2_post'][i])
        gate = jax.nn.sigmoid(rmsnorm(h, P['g_ple_pre'][i]) @ P['w_ple_gate'][i])
        h = h + rmsnorm((p[i] @ P['w_ple_proj'][i]) * gate, P['g_ple_post'][i])
        npool.append(a1); nsc.append(a2); ncf.append(a3)
    return rmsnorm(h, P['g_final']), jnp.stack(npool), jnp.stack(nsc), jnp.stack(ncf)


def setup_inputs(seed: int = 0) -> dict:
    key = jax.random.key(seed)
    ks = iter(jax.random.split(key, 64))
    f32 = jnp.float32

    def nrm(shape, scale=1.0):
        return jax.random.normal(next(ks), shape, f32) * scale

    def gain(shape):
        return 1.0 + 0.05 * jax.random.normal(next(ks), shape, f32)

    d = {}
    d['x_prompt'] = nrm((BATCH, SEQ, D_MODEL))
    d['x_sample'] = nrm((DEC_BATCH, DEC_SEQ, D_MODEL))
    d['p_prompt'] = nrm((DEPTH, BATCH, SEQ, PLE_DIM))
    d['p_sample'] = nrm((DEPTH, DEC_BATCH, DEC_SEQ, PLE_DIM))
    d['state_pool'] = nrm((DEPTH, DEC_BATCH, POOL_BUF, W_POOL))
    d['state_sconv'] = nrm((DEPTH, DEC_BATCH, SCONV_K - 1, W_SCONV))
    d['state_cconv'] = nrm((DEPTH, DEC_BATCH, CCONV_K - 1, W_CCONV), 0.5)
    d['g_f1_pre'] = gain((DEPTH, D_MODEL))
    d['w_f1_gate'] = nrm((DEPTH, D_MODEL, D_FF), D_MODEL ** -0.5)
    d['w_f1_up'] = nrm((DEPTH, D_MODEL, D_FF), D_MODEL ** -0.5)
    d['w_f1_down'] = nrm((DEPTH, D_FF, D_MODEL), D_FF ** -0.5)
    d['g_f1_post'] = gain((DEPTH, D_MODEL))
    d['g_mix_pre'] = gain((DEPTH, D_MODEL))
    d['w_in'] = nrm((DEPTH, D_MODEL, IN_COLS), D_MODEL ** -0.5)
    d['pool_w'] = nrm((DEPTH, N_POOL_GROUPS, POOL_GROUP, POOL_GROUP), POOL_GROUP ** -0.5)
    d['pool_scale'] = gain((DEPTH, W_POOL))
    d['w_pool_out'] = nrm((DEPTH, W_POOL, D_MODEL), W_POOL ** -0.5)
    d['sc_conv'] = nrm((DEPTH, SCONV_K, W_SCONV), SCONV_K ** -0.5)
    d['w_sc_out'] = nrm((DEPTH, W_SCONV, D_MODEL), W_SCONV ** -0.5)
    d['cf_conv'] = nrm((DEPTH, CCONV_K, W_CCONV), CCONV_K ** -0.5)
    d['cf_conv_b'] = nrm((DEPTH, W_CCONV), 0.01)
    d['cf_ln_g'] = gain((DEPTH, W_CCONV))
    d['cf_ln_b'] = nrm((DEPTH, W_CCONV), 0.01)
    d['w_cf_out'] = nrm((DEPTH, W_CCONV, D_MODEL), W_CCONV ** -0.5)
    d['w_o'] = nrm((DEPTH, D_MODEL, D_MODEL), D_MODEL ** -0.5)
    d['g_mix_post'] = gain((DEPTH, D_MODEL))
    d['g_f2_pre'] = gain((DEPTH, D_MODEL))
    d['w_f2_gate'] = nrm((DEPTH, D_MODEL, D_FF), D_MODEL ** -0.5)
    d['w_f2_up'] = nrm((DEPTH, D_MODEL, D_FF), D_MODEL ** -0.5)
    d['w_f2_down'] = nrm((DEPTH, D_FF, D_MODEL), D_FF ** -0.5)
    d['g_f2_post'] = gain((DEPTH, D_MODEL))
    d['g_ple_pre'] = gain((DEPTH, D_MODEL))
    d['w_ple_gate'] = nrm((DEPTH, D_MODEL, D_MODEL), D_MODEL ** -0.5)
    d['w_ple_proj'] = nrm((DEPTH, PLE_DIM, D_MODEL), PLE_DIM ** -0.5)
    d['g_ple_post'] = gain((DEPTH, D_MODEL))
    d['g_final'] = gain((D_MODEL,))
    return d


def reference(x_prompt, x_sample, p_prompt, p_sample, state_pool, state_sconv, state_cconv,
              g_f1_pre, w_f1_gate, w_f1_up, w_f1_down, g_f1_post,
              g_mix_pre, w_in, pool_w, pool_scale, w_pool_out, sc_conv, w_sc_out,
              cf_conv, cf_conv_b, cf_ln_g, cf_ln_b, w_cf_out, w_o, g_mix_post,
              g_f2_pre, w_f2_gate, w_f2_up, w_f2_down, g_f2_post,
              g_ple_pre, w_ple_gate, w_ple_proj, g_ple_post, g_final):
    P = dict(g_f1_pre=g_f1_pre, w_f1_gate=w_f1_gate, w_f1_up=w_f1_up, w_f1_down=w_f1_down, g_f1_post=g_f1_post,
             g_mix_pre=g_mix_pre, w_in=w_in, pool_w=pool_w, pool_scale=pool_scale, w_pool_out=w_pool_out,
             sc_conv=sc_conv, w_sc_out=w_sc_out, cf_conv=cf_conv, cf_conv_b=cf_conv_b, cf_ln_g=cf_ln_g,
             cf_ln_b=cf_ln_b, w_cf_out=w_cf_out, w_o=w_o, g_mix_post=g_mix_post,
             g_f2_pre=g_f2_pre, w_f2_gate=w_f2_gate, w_f2_up=w_f2_up, w_f2_down=w_f2_down, g_f2_post=g_f2_post,
             g_ple_pre=g_ple_pre, w_ple_gate=w_ple_gate, w_ple_proj=w_ple_proj, g_ple_post=g_ple_post,
             g_final=g_final)
    dt = x_prompt.dtype
    zp = jnp.zeros((DEPTH, BATCH, POOL_BUF, W_POOL), dt)
    zs = jnp.zeros((DEPTH, BATCH, SCONV_K - 1, W_SCONV), dt)
    zc = jnp.zeros((DEPTH, BATCH, CCONV_K - 1, W_CCONV), dt)
    y_prompt, npool_p, nsc_p, ncf_p = trunk(x_prompt, p_prompt, zp, zs, zc, 0, P)
    y_sample, npool_s, nsc_s, ncf_s = trunk(x_sample, p_sample, state_pool, state_sconv, state_cconv, PAST_LEN, P)
    return (y_prompt, y_sample, npool_p, nsc_p, ncf_p, npool_s, nsc_s, ncf_s)
```

```cpp
#include <hip/hip_runtime.h>
#include <cstdio>
#include <cstdint>

#ifndef MK_SINGLE
#define MK_SINGLE 0
#endif

__device__ __forceinline__ int lane_id_() { int l; asm volatile("v_mbcnt_lo_u32_b32 %0, -1, 0\n\tv_mbcnt_hi_u32_b32 %0, -1, %0" : "=v"(l)); return l; }
namespace pg8 {
#define PG8_LAS __attribute__((address_space(3)))
typedef unsigned short bf16_t;
typedef short bf16x8 __attribute__((ext_vector_type(8)));
typedef float f32x4 __attribute__((ext_vector_type(4)));
typedef float f32x2 __attribute__((ext_vector_type(2)));
typedef unsigned u32x4 __attribute__((ext_vector_type(4)));
typedef unsigned u32x2 __attribute__((ext_vector_type(2)));
constexpr int BM = 256, BK = 64, HALF = 128, HTB = HALF * BK * 2, STAGE_BYTES = 8 * HTB, NXCD = 8, WGM = 8;

__host__ __device__ __forceinline__ int lds_byte(int r, int c) { const int st = (r >> 4) * 2 + (c >> 5), rr = r & 15, cc = c & 31, ob = rr * 64 + cc * 2; return st * 1024 + (ob ^ (((ob >> 9) & 1) << 5)); }
__host__ __device__ __forceinline__ void stage_rc(int b, int& R, int& C) { const int st = b / 1024, sb = b % 1024, swz = sb ^ (((sb >> 9) & 1) << 5); R = (st >> 1) * 16 + swz / 64; C = (st & 1) * 32 + (swz % 64) / 2; }
__host__ __device__ __forceinline__ int perm32(int rho) { const int n = rho >> 4, i = rho & 15; return 8 * (i >> 2) + 4 * n + (i & 3); }

struct Unit { int pm, pn, sub; };
struct Gemm { const bf16_t* A; const bf16_t* Bt; int lda, ldb, K; int subA, subB; };

struct StaticOrder {
    int nM, nN, nsub, nwg, G, c;
    __host__ __device__ void init(int M, int N, int nsub_, int G_, int c_) { nM = M / BM; nN = N / BM; nsub = nsub_; nwg = nM * nN; G = G_; c = c_; }
    __host__ __device__ bool next(int i, Unit& u) const {
        const int ii = i / nsub; u.sub = i - ii * nsub;
        const long L = (long)ii * G + c; if (L >= nwg) return false;
        int wgid = (int)L; { const int q = nwg / NXCD, r = nwg % NXCD, xcd = wgid % NXCD, off = wgid / NXCD; wgid = (xcd < r ? xcd * (q + 1) : r * (q + 1) + (xcd - r) * q) + off; }
        const int nig = WGM * nN, gid = wgid / nig, fm = gid * WGM, gsz = (nM - fm) < WGM ? (nM - fm) : WGM;
        u.pm = fm + ((wgid % nig) % gsz); u.pn = (wgid % nig) / gsz; return true;
    }
};

typedef __bf16 bf16x2_t __attribute__((ext_vector_type(2)));
__device__ __forceinline__ unsigned cvt_pk_bf16(float lo, float hi) { f32x2 v = {lo, hi}; bf16x2_t b = __builtin_convertvector(v, bf16x2_t); return __builtin_bit_cast(unsigned, b); }
__device__ __forceinline__ float bf_lo(unsigned w) { return __builtin_bit_cast(float, w << 16); }
__device__ __forceinline__ float bf_hi(unsigned w) { return __builtin_bit_cast(float, w & 0xffff0000u); }
__device__ __forceinline__ float sigmoidf_(float x) { return __builtin_amdgcn_rcpf(1.0f + __builtin_amdgcn_exp2f(-1.44269504089f * x)); }
__device__ __forceinline__ f32x4 sigmoid4(f32x4 v) { f32x4 r; r.x = sigmoidf_(v.x); r.y = sigmoidf_(v.y); r.z = sigmoidf_(v.z); r.w = sigmoidf_(v.w); return r; }
__device__ __forceinline__ u32x4 pack8(f32x4 a, f32x4 b) { u32x4 w; w.x = cvt_pk_bf16(a.x, a.y); w.y = cvt_pk_bf16(a.z, a.w); w.z = cvt_pk_bf16(b.x, b.y); w.w = cvt_pk_bf16(b.z, b.w); return w; }
__device__ __forceinline__ void unpack8(u32x4 w, f32x4& a, f32x4& b) { a.x = bf_lo(w.x); a.y = bf_hi(w.x); a.z = bf_lo(w.y); a.w = bf_hi(w.y); b.x = bf_lo(w.z); b.y = bf_hi(w.z); b.z = bf_lo(w.w); b.w = bf_hi(w.w); }

typedef f32x4 AccT[2][2][4][2];

struct EpiF32 {
    static constexpr bool PERM = false;
    float* C; int ldc;
    __device__ __forceinline__ void operator()(const AccT& acc, const Unit& u, int wr, int wc, int fr, int fq) const {
        const int row0 = u.pm * BM + wr * 64 + fr, col0 = u.pn * BM + wc * 32 + 4 * fq;
#pragma unroll
        for (int ai = 0; ai < 2; ++ai)
#pragma unroll
            for (int m = 0; m < 4; ++m) { float* rowp = C + (size_t)(row0 + ai * HALF + m * 16) * ldc + col0;
#pragma unroll
                for (int bj = 0; bj < 2; ++bj)
#pragma unroll
                    for (int n = 0; n < 2; ++n) *(f32x4*)(rowp + bj * HALF + n * 16) = acc[ai][bj][m][n]; }
    }
};
struct EpiBf16 {
    static constexpr bool PERM = true;
    bf16_t* O; int ldc;
    __device__ __forceinline__ void operator()(const AccT& acc, const Unit& u, int wr, int wc, int fr, int fq) const {
        const int row0 = u.pm * BM + wr * 64 + fr, col0 = u.pn * BM + wc * 32 + 8 * fq;
#pragma unroll
        for (int ai = 0; ai < 2; ++ai)
#pragma unroll
            for (int m = 0; m < 4; ++m) { bf16_t* rowp = O + (size_t)(row0 + ai * HALF + m * 16) * ldc + col0;
#pragma unroll
                for (int bj = 0; bj < 2; ++bj) *(u32x4*)(rowp + bj * HALF) = pack8(acc[ai][bj][m][0], acc[ai][bj][m][1]); }
    }
};
struct EpiSwiglu {
    static constexpr bool PERM = true;
    bf16_t* O; int ldc;
    __device__ __forceinline__ void operator()(const AccT& acc, const Unit& u, int wr, int wc, int fr, int fq) const {
        const int row0 = u.pm * BM + wr * 64 + fr, col0 = u.pn * HALF + wc * 32 + 8 * fq;
#pragma unroll
        for (int ai = 0; ai < 2; ++ai)
#pragma unroll
            for (int m = 0; m < 4; ++m) {
                const f32x4 g0 = acc[ai][0][m][0], g1 = acc[ai][0][m][1];
                const f32x4 v0 = g0 * sigmoid4(g0) * acc[ai][1][m][0], v1 = g1 * sigmoid4(g1) * acc[ai][1][m][1];
                *(u32x4*)(O + (size_t)(row0 + ai * HALF + m * 16) * ldc + col0) = pack8(v0, v1); }
    }
};
struct EpiZ {
    static constexpr bool PERM = true;
    bf16_t* ZC; bf16_t* SG;
    __device__ __forceinline__ void operator()(const AccT& acc, const Unit& u, int wr, int wc, int fr, int fq) const {
        const int row0 = u.pm * BM + wr * 64 + fr, cw = wc * 32 + 8 * fq, pn = u.pn;
        if (pn >= 12) {
#pragma unroll
            for (int ai = 0; ai < 2; ++ai)
#pragma unroll
                for (int m = 0; m < 4; ++m) { bf16_t* rowp = SG + (size_t)(row0 + ai * HALF + m * 16) * 3072 + (pn - 12) * 256 + cw;
#pragma unroll
                    for (int bj = 0; bj < 2; ++bj) *(u32x4*)(rowp + bj * HALF) = pack8(sigmoid4(acc[ai][bj][m][0]), sigmoid4(acc[ai][bj][m][1])); }
        } else if (pn < 2 || pn == 6 || pn == 7) {
            const int cb = (pn < 2) ? pn * 256 : 1024 + (pn - 6) * 256;
#pragma unroll
            for (int ai = 0; ai < 2; ++ai)
#pragma unroll
                for (int m = 0; m < 4; ++m) { bf16_t* rowp = ZC + (size_t)(row0 + ai * HALF + m * 16) * 2048 + cb + cw;
#pragma unroll
                    for (int bj = 0; bj < 2; ++bj) *(u32x4*)(rowp + bj * HALF) = pack8(acc[ai][bj][m][0], acc[ai][bj][m][1]); }
        } else if (pn < 6) {
            const int cb = 512 + (pn - 2) * 128;
#pragma unroll
            for (int ai = 0; ai < 2; ++ai)
#pragma unroll
                for (int m = 0; m < 4; ++m)
                    *(u32x4*)(ZC + (size_t)(row0 + ai * HALF + m * 16) * 2048 + cb + cw) = pack8(acc[ai][0][m][0] * acc[ai][1][m][0], acc[ai][0][m][1] * acc[ai][1][m][1]);
        } else {
            const int cb = 1536 + (pn - 8) * 128;
#pragma unroll
            for (int ai = 0; ai < 2; ++ai)
#pragma unroll
                for (int m = 0; m < 4; ++m)
                    *(u32x4*)(ZC + (size_t)(row0 + ai * HALF + m * 16) * 2048 + cb + cw) = pack8(acc[ai][0][m][0] * sigmoid4(acc[ai][1][m][0]), acc[ai][0][m][1] * sigmoid4(acc[ai][1][m][1]));
        }
    }
};
struct EpiBranch {
    static constexpr bool PERM = true;
    const bf16_t* SG; bf16_t* TMP; bf16_t* Mo;
    __device__ __forceinline__ void operator()(const AccT& acc, const Unit& u, int wr, int wc, int fr, int fq) const {
        const int row0 = u.pm * BM + wr * 64 + fr, col0 = u.pn * BM + wc * 32 + 8 * fq, b = u.sub;
#pragma unroll
        for (int ai = 0; ai < 2; ++ai)
#pragma unroll
            for (int m = 0; m < 4; ++m) { const size_t row = (size_t)(row0 + ai * HALF + m * 16);
#pragma unroll
                for (int bj = 0; bj < 2; ++bj) {
                    const int col = col0 + bj * HALF; f32x4 s0, s1; unpack8(*(const u32x4*)(SG + row * 3072 + b * 1024 + col), s0, s1);
                    f32x4 t0 = s0 * acc[ai][bj][m][0], t1 = s1 * acc[ai][bj][m][1];
                    if (b < 2) *(u32x4*)(TMP + (size_t)b * ((size_t)17408 * 1024) + row * 1024 + col) = pack8(t0, t1);
                    else { f32x4 p0, p1, q0, q1; unpack8(*(const u32x4*)(TMP + row * 1024 + col), p0, p1); unpack8(*(const u32x4*)(TMP + (size_t)17408 * 1024 + row * 1024 + col), q0, q1);
                        *(u32x4*)(Mo + row * 1024 + col) = pack8(t0 + p0 + q0, t1 + p1 + q1); }
                } }
    }
};
struct EpiPle {
    static constexpr bool PERM = true;
    const bf16_t* PP; float* F;
    __device__ __forceinline__ void operator()(const AccT& acc, const Unit& u, int wr, int wc, int fr, int fq) const {
        const int row0 = u.pm * BM + wr * 64 + fr, col0 = u.pn * BM + wc * 32 + 8 * fq;
#pragma unroll
        for (int ai = 0; ai < 2; ++ai)
#pragma unroll
            for (int m = 0; m < 4; ++m) { const size_t row = (size_t)(row0 + ai * HALF + m * 16);
#pragma unroll
                for (int bj = 0; bj < 2; ++bj) {
                    const int col = col0 + bj * HALF; f32x4 p0, p1; unpack8(*(const u32x4*)(PP + row * 1024 + col), p0, p1);
                    float* fp = F + row * 1024 + col;
                    *(f32x4*)fp = p0 * sigmoid4(acc[ai][bj][m][0]); *(f32x4*)(fp + 4) = p1 * sigmoid4(acc[ai][bj][m][1]);
                } }
    }
};

template <class Epi, class Sched, bool ALIGN_EPI = false, bool SP2 = false>
__device__ __forceinline__ void gemm_phase(PG8_LAS unsigned char* lds, const Gemm g, const Sched& S, const Epi& E, const int wid) {
    const int lane = lane_id_(), tid = wid * 64 + lane, wr = wid >> 2, wc = wid & 3, fr = lane & 15, fq = lane >> 4;
    const int K = g.K, nt = K / BK;
    unsigned voffA[2], voffB[2];
#pragma unroll
    for (int i = 0; i < 2; ++i) { int R, C; stage_rc(tid * 16 + i * 8192, R, C); const int Rb = Epi::PERM ? ((R & ~31) + perm32(R & 31)) : R;
        voffA[i] = (unsigned)(R * g.lda + C) * 2u; voffB[i] = (unsigned)(Rb * g.ldb + C) * 2u; }
    const size_t kstep = (size_t)(BK * 2);
    const size_t hstepA = (size_t)HALF * g.lda * 2, hstepB = (size_t)HALF * g.ldb * 2;
    const size_t tstepA = 2 * hstepA, tstepB = 2 * hstepB;
    const unsigned ldsw = (unsigned)wid * 1024u;
    const int aoff = lds_byte(wr * 64 + fr, fq * 8), boff = lds_byte(wc * 32 + fr, fq * 8);
#define PG8_SA(b, h) (((b) * 2 + (h)) * HTB)
#define PG8_SB(b, h) ((4 + (b) * 2 + (h)) * HTB)
#define PG8_STAGE(bufoff, gbase, voff) do { _Pragma("unroll") for (int _i = 0; _i < 2; ++_i) \
        __builtin_amdgcn_global_load_lds((const unsigned*)((const char*)(gbase) + (voff)[_i]), (PG8_LAS unsigned*)(lds + (bufoff) + ldsw + _i * 8192), 16, 0, 0); } while (0)
#define PG8_LDA(dst, b, h) do { _Pragma("unroll") for (int m = 0; m < 4; ++m) _Pragma("unroll") for (int k = 0; k < 2; ++k) dst[m][k] = *(const PG8_LAS bf16x8*)(lds + PG8_SA(b, h) + aoff + m * 2048 + k * 1024); } while (0)
#define PG8_LDB(dst, b, h) do { _Pragma("unroll") for (int n = 0; n < 2; ++n) _Pragma("unroll") for (int k = 0; k < 2; ++k) dst[n][k] = *(const PG8_LAS bf16x8*)(lds + PG8_SB(b, h) + boff + n * 2048 + k * 1024); } while (0)
#define PG8_MMA(ai, bj, At, Bt) do { __builtin_amdgcn_s_setprio(1); _Pragma("unroll") for (int m = 0; m < 4; ++m) _Pragma("unroll") for (int n = 0; n < 2; ++n) _Pragma("unroll") for (int k = 0; k < 2; ++k) \
        acc[ai][bj][m][n] = __builtin_amdgcn_mfma_f32_16x16x32_bf16(Bt[n][k], At[m][k], acc[ai][bj][m][n], 0, 0, 0); __builtin_amdgcn_s_setprio(0); } while (0)
#define PG8_WAIT_V(n) asm volatile("s_waitcnt vmcnt(" #n ")" ::: "memory")
#define PG8_WAIT_L(n) asm volatile("s_waitcnt lgkmcnt(" #n ")" ::: "memory")
#define PG8_BAR __builtin_amdgcn_s_barrier()
#define PG8_SCHED __builtin_amdgcn_sched_barrier(0)
    Unit cur, nxt; int ui = 0;
    if (!S.next(0, cur)) return;
    f32x4 acc[2][2][4][2];
#pragma unroll
    for (int a = 0; a < 2; ++a)
#pragma unroll
        for (int b = 0; b < 2; ++b)
#pragma unroll
            for (int m = 0; m < 4; ++m)
#pragma unroll
                for (int n = 0; n < 2; ++n) acc[a][b][m][n] = (f32x4){0.f, 0.f, 0.f, 0.f};
    bf16x8 At[4][2], B0[2][2], B1[2][2];
    const char* cA = (const char*)g.A + (size_t)cur.pm * tstepA + (size_t)cur.sub * g.subA; const char* cB = (const char*)g.Bt + (size_t)cur.pn * tstepB + (size_t)cur.sub * g.subB;
    if constexpr (SP2) {
        PG8_STAGE(PG8_SB(0, 0), cB, voffB); PG8_STAGE(PG8_SB(0, 1), cB + hstepB, voffB); PG8_STAGE(PG8_SA(0, 0), cA, voffA); PG8_STAGE(PG8_SA(0, 1), cA + hstepA, voffA);
        if (wr == 1) PG8_BAR;
        PG8_WAIT_V(2); PG8_BAR;
        PG8_STAGE(PG8_SB(1, 0), cB + kstep, voffB); PG8_STAGE(PG8_SA(1, 0), cA + kstep, voffA); PG8_STAGE(PG8_SB(1, 1), cB + hstepB + kstep, voffB);
        PG8_WAIT_V(6); PG8_BAR;
    } else {
        PG8_STAGE(PG8_SB(0, 0), cB, voffB); PG8_STAGE(PG8_SA(0, 0), cA, voffA); PG8_STAGE(PG8_SB(0, 1), cB + hstepB, voffB); PG8_STAGE(PG8_SA(0, 1), cA + hstepA, voffA);
        if (wr == 1) PG8_BAR;
        PG8_WAIT_V(4); PG8_BAR;
        PG8_STAGE(PG8_SB(1, 0), cB + kstep, voffB); PG8_STAGE(PG8_SA(1, 0), cA + kstep, voffA); PG8_STAGE(PG8_SB(1, 1), cB + hstepB + kstep, voffB);
        PG8_WAIT_V(6); PG8_BAR;
    }
    for (;;) {
        const bool has_next = S.next(ui + 1, nxt);
        const char* nA = has_next ? (const char*)g.A + (size_t)nxt.pm * tstepA + (size_t)nxt.sub * g.subA : cA; const char* nB = has_next ? (const char*)g.Bt + (size_t)nxt.pn * tstepB + (size_t)nxt.sub * g.subB : cB;
        for (int t = 0; t < nt; t += 2) {
            const bool last = (t == nt - 2);
            const char* a1 = cA + (size_t)(t + 1) * kstep;
            const char* a2 = last ? nA : cA + (size_t)(t + 2) * kstep; const char* b2 = last ? nB : cB + (size_t)(t + 2) * kstep;
            const char* a3 = a2 + kstep; const char* b3 = b2 + kstep;
            if constexpr (SP2) {
            PG8_LDB(B0, 0, 0); PG8_LDB(B1, 0, 1); PG8_SCHED; PG8_LDA(At, 0, 0); PG8_STAGE(PG8_SA(1, 1), a1 + hstepA, voffA);
            PG8_WAIT_V(8); PG8_WAIT_L(0); PG8_BAR; PG8_MMA(0, 0, At, B0); PG8_MMA(0, 1, At, B1); PG8_BAR; PG8_SCHED;
            PG8_LDA(At, 0, 1); PG8_STAGE(PG8_SB(0, 0), b2, voffB); PG8_STAGE(PG8_SB(0, 1), b2 + hstepB, voffB); PG8_STAGE(PG8_SA(0, 0), a2, voffA);
            PG8_WAIT_V(8); PG8_WAIT_L(0); PG8_BAR; PG8_MMA(1, 0, At, B0); PG8_MMA(1, 1, At, B1); PG8_BAR; PG8_SCHED;
            PG8_LDB(B0, 1, 0); PG8_LDB(B1, 1, 1); PG8_SCHED; PG8_LDA(At, 1, 0); PG8_STAGE(PG8_SA(0, 1), a2 + hstepA, voffA);
            PG8_WAIT_V(8); PG8_WAIT_L(0); PG8_BAR; PG8_MMA(0, 0, At, B0); PG8_MMA(0, 1, At, B1); PG8_BAR; PG8_SCHED;
            PG8_LDA(At, 1, 1); PG8_STAGE(PG8_SB(1, 0), b3, voffB); PG8_STAGE(PG8_SB(1, 1), b3 + hstepB, voffB); PG8_STAGE(PG8_SA(1, 0), a3, voffA);
            PG8_WAIT_V(8); PG8_WAIT_L(0); PG8_BAR; PG8_MMA(1, 0, At, B0); PG8_MMA(1, 1, At, B1); PG8_BAR; PG8_SCHED;
            } else {
            PG8_LDB(B0, 0, 0); PG8_SCHED; PG8_LDA(At, 0, 0); PG8_STAGE(PG8_SA(1, 1), a1 + hstepA, voffA);
            PG8_WAIT_L(8); PG8_BAR; PG8_WAIT_L(0); PG8_MMA(0, 0, At, B0); PG8_BAR; PG8_SCHED;
            PG8_LDB(B1, 0, 1); PG8_STAGE(PG8_SB(0, 0), b2, voffB);
            PG8_BAR; PG8_WAIT_L(0); PG8_MMA(0, 1, At, B1); PG8_BAR;
            PG8_LDA(At, 0, 1); PG8_STAGE(PG8_SA(0, 0), a2, voffA);
            PG8_BAR; PG8_WAIT_L(0); PG8_MMA(1, 0, At, B0); PG8_BAR; PG8_SCHED;
            PG8_STAGE(PG8_SB(0, 1), b2 + hstepB, voffB);
            PG8_WAIT_V(6); PG8_BAR; PG8_MMA(1, 1, At, B1); PG8_BAR;
            PG8_LDB(B0, 1, 0); PG8_SCHED; PG8_LDA(At, 1, 0); PG8_STAGE(PG8_SA(0, 1), a2 + hstepA, voffA);
            PG8_WAIT_L(8); PG8_BAR; PG8_WAIT_L(0); PG8_MMA(0, 0, At, B0); PG8_BAR; PG8_SCHED;
            PG8_LDB(B1, 1, 1); PG8_STAGE(PG8_SB(1, 0), b3, voffB);
            PG8_BAR; PG8_WAIT_L(0); PG8_MMA(0, 1, At, B1); PG8_BAR;
            PG8_LDA(At, 1, 1); PG8_STAGE(PG8_SA(1, 0), a3, voffA);
            PG8_BAR; PG8_WAIT_L(0); PG8_MMA(1, 0, At, B0); PG8_BAR; PG8_SCHED;
            PG8_STAGE(PG8_SB(1, 1), b3 + hstepB, voffB);
            PG8_WAIT_V(6); PG8_BAR; PG8_MMA(1, 1, At, B1); PG8_BAR;
            }
        }
        if constexpr (ALIGN_EPI) { if (wr == 0) PG8_BAR; }
        { const int l2 = lane_id_(); E(acc, cur, wr, wc, l2 & 15, l2 >> 4); }
        if (!has_next) break;
#pragma unroll
        for (int a = 0; a < 2; ++a)
#pragma unroll
            for (int b = 0; b < 2; ++b)
#pragma unroll
                for (int m = 0; m < 4; ++m)
#pragma unroll
                    for (int n = 0; n < 2; ++n) acc[a][b][m][n] = (f32x4){0.f, 0.f, 0.f, 0.f};
        cur = nxt; cA = nA; cB = nB; ++ui;
        if constexpr (ALIGN_EPI) { if (wr == 1) PG8_BAR; }
    }
    PG8_WAIT_V(0);
    if constexpr (!ALIGN_EPI) { if (wr == 0) PG8_BAR; }
    PG8_BAR;
#undef PG8_SA
#undef PG8_SB
#undef PG8_STAGE
#undef PG8_LDA
#undef PG8_LDB
#undef PG8_MMA
#undef PG8_WAIT_V
#undef PG8_WAIT_L
#undef PG8_BAR
#undef PG8_SCHED
}
}

constexpr int NWAVES = 8;
constexpr int T = 17408, TP = 16384, D = 1024, FF = 2816, NIN = 6144, PLE = 256, DEPTH = 2;
constexpr float EPS = 1e-6f;
constexpr size_t O_PP = (size_t)T * D, O_SP = O_PP + 2 * 8 * 15 * 512, O_CP = O_SP + 2 * 8 * 2 * 512, O_PS = O_CP + 2 * 8 * 30 * 512, O_SS = O_PS + 2 * 128 * 15 * 512, O_CS = O_SS + 2 * 128 * 2 * 512, O_END = O_CS + 2 * 128 * 30 * 512;
constexpr size_t MiB = 1u << 20;
constexpr size_t WS_CTL = 0, CTL_ZERO_BYTES = 1 * MiB;
constexpr size_t WS_WGU1 = 1 * MiB, WS_WD1 = WS_WGU1 + (size_t)2 * FF * D * 2, WS_WIN = WS_WD1 + (size_t)D * FF * 2, WS_WBR = WS_WIN + (size_t)NIN * D * 2, WS_WO = WS_WBR + (size_t)3 * D * 512 * 2,
                 WS_WGU2 = WS_WO + (size_t)D * D * 2, WS_WD2 = WS_WGU2 + (size_t)2 * FF * D * 2, WS_WPG = WS_WD2 + (size_t)D * FF * 2, WS_WPP = WS_WPG + (size_t)D * D * 2, WS_WEND = WS_WPP + (size_t)D * PLE * 2;
constexpr size_t WS_P16 = 54 * MiB, WS_U = 63 * MiB, WS_ZC = 97 * MiB, WS_SG = 165 * MiB, WS_Y = 267 * MiB, WS_END = 318 * MiB;
static_assert(WS_WEND <= WS_P16 && WS_P16 + (size_t)T * PLE * 2 <= WS_U && WS_U + (size_t)T * D * 2 <= WS_ZC && WS_ZC + (size_t)T * 2048 * 2 <= WS_SG && WS_ZC + (size_t)T * D * 4 <= WS_SG &&
              WS_SG + (size_t)T * 3072 * 2 <= WS_Y && WS_SG + (size_t)T * FF * 2 <= WS_Y && WS_Y + (size_t)T * 1536 * 2 <= WS_END, "d_ws map");
constexpr int CW_BAR = 4096;
constexpr int RING_OFF = 0, RING_BYTES = 131072, LDSCTL_OFF = RING_BYTES, MISC_OFF = LDSCTL_OFF + 320, LDS_BYTES = 147456;

#define GAS __attribute__((address_space(1)))
#define LAS __attribute__((address_space(3)))
typedef unsigned short bf16;
typedef unsigned v4u __attribute__((ext_vector_type(4)));
typedef float f32x4 __attribute__((ext_vector_type(4)));
typedef GAS unsigned gu32;
#define RLX_AGENT __ATOMIC_RELAXED, __HIP_MEMORY_SCOPE_AGENT
#define LDS_WAIT() asm volatile("s_waitcnt lgkmcnt(0)" ::: "memory")
__device__ __forceinline__ unsigned f2bf(float f) { unsigned u = __builtin_bit_cast(unsigned, f); return (u + 0x7fffu + ((u >> 16) & 1u)) >> 16; }
__device__ __forceinline__ unsigned pk2(float lo, float hi) { return f2bf(lo) | (f2bf(hi) << 16); }

#define XB_TMO      128
#define XB_XCNT(j)  (256  + 64 * (j))
#define XB_XSUB(j)  (1280 + 64 * (j))
#define XB_XGEN(j)  (2304 + 64 * (j))
#define XB_TOP      3328
#define XB_TOPGEN   3392
#define XCD_BAR_WORDS 3456
#define XB_SPIN_CAP (1u << 18)
__device__ __forceinline__ unsigned xb_ld(unsigned* p)              { return __hip_atomic_load(p, __ATOMIC_RELAXED, __HIP_MEMORY_SCOPE_AGENT); }
__device__ __forceinline__ unsigned xb_add(unsigned* p, unsigned v) { return __hip_atomic_fetch_add(p, v, __ATOMIC_RELAXED, __HIP_MEMORY_SCOPE_AGENT); }
__device__ __forceinline__ unsigned xb_xcc_id() { return (unsigned)__builtin_amdgcn_s_getreg((3 << 11) | 20) & 0xFu; }
#define XB_SPIN(cond, bar) do { unsigned _sp = 0; while (cond) { __builtin_amdgcn_s_sleep(1); \
    if ((++_sp & 255u) == 0u) { if (xb_ld(&(bar)[XB_TMO])) break; if (_sp > XB_SPIN_CAP) { atomicAdd(&(bar)[XB_TMO], 1u); break; } } } } while (0)
struct XcdBarrier { unsigned* bar; unsigned x; volatile LAS unsigned* st; };
__device__ __forceinline__ XcdBarrier xcd_barrier_post(unsigned* bar, volatile LAS unsigned* st) {
    XcdBarrier b; b.bar = bar; b.x = xb_xcc_id(); b.st = st;
    if (threadIdx.x == 0) (void)xb_add(&bar[XB_XCNT(b.x)], 1u);
    return b;
}
__device__ __forceinline__ void xcd_barrier_complete(unsigned* bar, unsigned x, unsigned& nloc, unsigned& nx) {
    const unsigned G = gridDim.x * gridDim.y * gridDim.z;
    unsigned sum, cnt, mine, sp = 0u;
    for (;;) {
        sum = 0u; cnt = 0u; mine = 0u;
#pragma unroll
        for (unsigned j = 0; j < 16; ++j) { const unsigned c = xb_ld(&bar[XB_XCNT(j)]); sum += c; cnt += (c > 0u) ? 1u : 0u; mine = (j == x) ? c : mine; }
        if (sum == G) break;
        __builtin_amdgcn_s_sleep(1);
        if ((++sp & 255u) == 0u) { if (xb_ld(&bar[XB_TMO])) break; if (sp > XB_SPIN_CAP) { atomicAdd(&bar[XB_TMO], 1u); break; } }
    }
    nloc = mine > 0u ? mine : 1u; nx = cnt > 0u ? cnt : 1u;
}
__device__ __forceinline__ void xcd_barrier(const XcdBarrier& b) {
    asm volatile("s_waitcnt vmcnt(0)" ::: "memory");
    __syncthreads();
    if (threadIdx.x == 0) {
        unsigned* bar = b.bar;
        __builtin_amdgcn_s_waitcnt(0);
        unsigned nloc = b.st[0], nx = b.st[1];
        if (nloc == 0u) { xcd_barrier_complete(bar, b.x, nloc, nx); b.st[0] = nloc; b.st[1] = nx; }
        const unsigned old = xb_add(&bar[XB_XSUB(b.x)], 1u);
        const unsigned gen = old / nloc;
        if (old + 1u == (gen + 1u) * nloc) {
            __builtin_amdgcn_fence(__ATOMIC_RELEASE, "agent");
            asm volatile("s_waitcnt vmcnt(0)" ::: "memory");
            const unsigned og = xb_add(&bar[XB_TOP], 1u);
            const unsigned tg = og / nx;
            if (og + 1u == (tg + 1u) * nx) xb_add(&bar[XB_TOPGEN], 1u);
            else XB_SPIN(xb_ld(&bar[XB_TOPGEN]) == tg, bar);
            __builtin_amdgcn_fence(__ATOMIC_ACQUIRE, "agent");
            xb_add(&bar[XB_XGEN(b.x)], 1u);
            asm volatile("s_waitcnt vmcnt(0)" ::: "memory");
        } else {
            XB_SPIN(xb_ld(&bar[XB_XGEN(b.x)]) == gen, bar);
            __builtin_amdgcn_fence(__ATOMIC_ACQUIRE, "agent");
            asm volatile("s_waitcnt vmcnt(0)" ::: "memory");
        }
    }
    __syncthreads();
}

struct Args { const float* in[36]; float* out; unsigned char* ws; int ph_lo, ph_hi; };
__device__ __forceinline__ int opq(int i);
__device__ __forceinline__ unsigned char* ld_ws(const Args& a);
__device__ __forceinline__ int ld_hi(const Args& a);
__device__ __forceinline__ int opq(int i) { asm volatile("" : "+s"(i)); return i; }
__device__ __forceinline__ unsigned char* ld_ws(const Args& a) { return *(unsigned char* const*)((const char*)&a + opq((int)__builtin_offsetof(Args, ws))); }
__device__ __forceinline__ int ld_hi(const Args& a) { return *(const int*)((const char*)&a + opq((int)__builtin_offsetof(Args, ph_hi))); }

__device__ __forceinline__ float wave_sum(float v) {
#pragma unroll
    for (int o = 1; o < 64; o <<= 1) v += __shfl_xor(v, o);
    return v;
}
struct f8 { f32x4 lo, hi; };
__device__ __forceinline__ f8 f8zero() { f8 r; r.lo = (f32x4){0.f, 0.f, 0.f, 0.f}; r.hi = r.lo; return r; }
__device__ __forceinline__ f8 ld_bf8(const bf16* p) { f8 r; pg8::unpack8(*(const v4u*)p, r.lo, r.hi); return r; }
__device__ __forceinline__ f8 ld_f8(const float* p) { f8 r; r.lo = *(const f32x4*)p; r.hi = *(const f32x4*)(p + 4); return r; }
__device__ __forceinline__ void fma8(f8& a, const f8& w, const f8& x) { a.lo += w.lo * x.lo; a.hi += w.hi * x.hi; }
__device__ __forceinline__ void fma8s(f8& a, float w, const f8& x) { a.lo += w * x.lo; a.hi += w * x.hi; }
__device__ __forceinline__ float sum8(const f8& a) { return ((a.lo.x + a.lo.y) + (a.lo.z + a.lo.w)) + ((a.hi.x + a.hi.y) + (a.hi.z + a.hi.w)); }

__device__ __forceinline__ void tr_item(const float* W, int N, bf16* WT, int K, int k0, int n0, int drow0, LAS float* scr, int lane) {
#pragma unroll 8
    for (int i = 0; i < 32; ++i) { const int kk = 2 * i + (lane >> 5); scr[kk * 33 + (lane & 31)] = W[(size_t)(k0 + kk) * N + n0 + (lane & 31)]; }
    LDS_WAIT(); asm volatile("" ::: "memory");
    const int c = lane & 7;
#pragma unroll
    for (int j = 0; j < 4; ++j) { const int n = (lane >> 3) + 8 * j; const LAS float* s = scr + (8 * c) * 33 + n;
        v4u o; o.x = pk2(s[0 * 33], s[1 * 33]); o.y = pk2(s[2 * 33], s[3 * 33]); o.z = pk2(s[4 * 33], s[5 * 33]); o.w = pk2(s[6 * 33], s[7 * 33]);
        *(GAS v4u*)(WT + (size_t)(drow0 + n) * K + k0 + 8 * c) = o; }
    LDS_WAIT(); asm volatile("" ::: "memory");
}
__device__ __forceinline__ int map_gu(int n, int up) { return (n >> 7) * 256 + up * 128 + (n & 127); }
__device__ __forceinline__ int map_in(int n) {
    if (n < 512) return n;
    if (n < 1024) { const int j = n - 512;  return 512 + (j >> 7) * 256 + (j & 127); }
    if (n < 1536) return 1536 + (n - 1024);
    if (n < 2048) { const int j = n - 1536; return 512 + (j >> 7) * 256 + 128 + (j & 127); }
    if (n < 2560) { const int j = n - 2048; return 2048 + (j >> 7) * 256 + (j & 127); }
    if (n < 3072) { const int j = n - 2560; return 2048 + (j >> 7) * 256 + 128 + (j & 127); }
    return n;
}

__device__ __forceinline__ void prep_phase(const Args& a, int l, LAS unsigned char* lds, int gw, int NGW, int wave) {
    const int lane = lane_id_();
    LAS float* scr = (LAS float*)(lds + RING_OFF + wave * 16384);
    unsigned char* ws = a.ws;
    constexpr int I_G = (D / 64) * (FF / 32), I_D = (FF / 64) * (D / 32), I_IN = (D / 64) * (NIN / 32), I_B = (512 / 64) * (D / 32), I_O = (D / 64) * (D / 32), I_PP = (PLE / 64) * (D / 32), I_FOLD = 4 * 16 * 16;
    constexpr int NITEMS = 6 * I_G + I_IN + 2 * I_B + 2 * I_O + I_PP + I_FOLD;
    static_assert(I_G == I_D, "items");
    for (int it = gw; it < NITEMS; it += NGW) {
        int r = it;
        if (r < 6 * I_G) {
            const int which = r / I_G; r -= which * I_G; const int ffn = which / 3, kind = which % 3;
            const float* W = a.in[opq((ffn ? 27 : 8) + kind)] + (size_t)l * D * FF;
            if (kind < 2) { const int nb = FF / 32, kb = r / nb, n0 = 32 * (r % nb); tr_item(W, FF, (bf16*)(ws + (ffn ? WS_WGU2 : WS_WGU1)), D, 64 * kb, n0, map_gu(n0, kind), scr, lane); }
            else { const int nb = D / 32, kb = r / nb, n0 = 32 * (r % nb); tr_item(W, D, (bf16*)(ws + (ffn ? WS_WD2 : WS_WD1)), FF, 64 * kb, n0, n0, scr, lane); }
            continue; }
        r -= 6 * I_G;
        if (r < I_IN) { const int nb = NIN / 32, kb = r / nb, n0 = 32 * (r % nb); tr_item(a.in[opq(13)] + (size_t)l * D * NIN, NIN, (bf16*)(ws + WS_WIN), D, 64 * kb, n0, map_in(n0), scr, lane); continue; }
        r -= I_IN;
        if (r < 2 * I_B) { const int which = r / I_B; r -= which * I_B; const int nb = D / 32, kb = r / nb, n0 = 32 * (r % nb);
            tr_item(a.in[opq(which ? 23 : 18)] + (size_t)l * 512 * D, D, (bf16*)(ws + WS_WBR) + (size_t)(1 + which) * D * 512, 512, 64 * kb, n0, n0, scr, lane); continue; }
        r -= 2 * I_B;
        if (r < 2 * I_O) { const int which = r / I_O; r -= which * I_O; const int nb = D / 32, kb = r / nb, n0 = 32 * (r % nb);
            tr_item(a.in[opq(which ? 32 : 24)] + (size_t)l * D * D, D, (bf16*)(ws + (which ? WS_WPG : WS_WO)), D, 64 * kb, n0, n0, scr, lane); continue; }
        r -= 2 * I_O;
        if (r < I_PP) { const int nb = D / 32, kb = r / nb, n0 = 32 * (r % nb); tr_item(a.in[opq(33)] + (size_t)l * PLE * D, D, (bf16*)(ws + WS_WPP), PLE, 64 * kb, n0, n0, scr, lane); continue; }
        r -= I_PP;
        {
            const int g = r >> 8, cb = (r >> 4) & 15, nb = r & 15, n = nb * 64 + lane, c0 = cb * 8;
            const float* pw = a.in[opq(14)] + (size_t)l * 4 * 128 * 128 + (size_t)(g * 128 + c0) * 128;
            const float* sc = a.in[opq(15)] + (size_t)l * 512 + g * 128;
            const float* wo = a.in[opq(16)] + (size_t)l * 512 * D + (size_t)(g * 128) * D + n;
            float acc[8];
#pragma unroll
            for (int i = 0; i < 8; ++i) acc[i] = 0.f;
            for (int d = 0; d < 128; ++d) { const float wv = wo[(size_t)d * D] * sc[d];
#pragma unroll
                for (int i = 0; i < 8; ++i) acc[i] += pw[i * 128 + d] * wv; }
            v4u o; o.x = pk2(acc[0], acc[1]); o.y = pk2(acc[2], acc[3]); o.z = pk2(acc[4], acc[5]); o.w = pk2(acc[6], acc[7]);
            *(GAS v4u*)((bf16*)(ws + WS_WBR) + (size_t)n * 512 + g * 128 + c0) = o;
        }
    }
    bf16* P16 = (bf16*)(ws + WS_P16);
    const int gt = gw * 64 + lane, NGT = NGW * 64;
    for (int i = gt; i < T * PLE / 8; i += NGT) {
        const size_t e = (size_t)i * 8; const int row = (int)(e / PLE), col = (int)(e % PLE);
        const float* src = (row < TP) ? a.in[opq(2)] + ((size_t)l * TP + row) * PLE + col : a.in[opq(3)] + ((size_t)l * (T - TP) + (row - TP)) * PLE + col;
        const f32x4 v0 = *(const f32x4*)src, v1 = *(const f32x4*)(src + 4);
        v4u o; o.x = pk2(v0.x, v0.y); o.y = pk2(v0.z, v0.w); o.z = pk2(v1.x, v1.y); o.w = pk2(v1.z, v1.w);
        *(GAS v4u*)(P16 + e) = o;
    }
}

template <int MODE>
__device__ __forceinline__ void row_pass(const Args& a, const float* F, float c, const float* gp, const float* gn, bf16* U, int gw, int NGW) {
    const int lane = lane_id_();
    float* H = a.out;
    f32x4 gpv[4], gnv[4];
#pragma unroll
    for (int j = 0; j < 4; ++j) { gnv[j] = *(const f32x4*)(gn + 4 * lane + 256 * j); if (MODE != 0) gpv[j] = *(const f32x4*)(gp + 4 * lane + 256 * j); }
    for (int m = gw; m < T; m += NGW) {
        f32x4 h[4];
        if (MODE == 0) {
            const float* xr = (m < TP) ? a.in[opq(0)] + (size_t)m * D : a.in[opq(1)] + (size_t)(m - TP) * D;
#pragma unroll
            for (int j = 0; j < 4; ++j) h[j] = *(const f32x4*)(xr + 4 * lane + 256 * j);
        } else {
            f32x4 f[4]; float s = 0.f;
#pragma unroll
            for (int j = 0; j < 4; ++j) { f[j] = *(const f32x4*)(F + (size_t)m * D + 4 * lane + 256 * j); h[j] = *(const f32x4*)(H + (size_t)m * D + 4 * lane + 256 * j);
                s += (f[j].x * f[j].x + f[j].y * f[j].y) + (f[j].z * f[j].z + f[j].w * f[j].w); }
            const float rf = c * __builtin_amdgcn_rsqf(wave_sum(s) * (1.f / D) + EPS);
#pragma unroll
            for (int j = 0; j < 4; ++j) h[j] += f[j] * gpv[j] * rf;
        }
        float s2 = 0.f;
#pragma unroll
        for (int j = 0; j < 4; ++j) s2 += (h[j].x * h[j].x + h[j].y * h[j].y) + (h[j].z * h[j].z + h[j].w * h[j].w);
        const float rh = __builtin_amdgcn_rsqf(wave_sum(s2) * (1.f / D) + EPS);
        if (MODE == 2) {
#pragma unroll
            for (int j = 0; j < 4; ++j) *(f32x4*)(H + (size_t)m * D + 4 * lane + 256 * j) = h[j] * gnv[j] * rh;
        } else {
#pragma unroll
            for (int j = 0; j < 4; ++j) { *(f32x4*)(H + (size_t)m * D + 4 * lane + 256 * j) = h[j];
                const f32x4 u = h[j] * gnv[j] * rh; pg8::u32x2 w; w.x = pg8::cvt_pk_bf16(u.x, u.y); w.y = pg8::cvt_pk_bf16(u.z, u.w);
                *(pg8::u32x2*)(U + (size_t)m * D + 4 * lane + 256 * j) = w; }
        }
    }
}

__device__ __forceinline__ float ldz(const bf16* ZC, int rowbase, int trow, int col, bool sample, const float* st, int BUF, int c) {
    if (trow >= 0) return __builtin_bit_cast(float, (unsigned)ZC[(size_t)(rowbase + trow) * 2048 + col + c] << 16);
    if (sample) return st[(size_t)(BUF + trow) * 512 + c];
    return 0.f;
}
__device__ __forceinline__ void st_bf(bf16* p, float v) { *p = (bf16)f2bf(v); }

__device__ __forceinline__ void conv_phase(const Args& a, int l, const bf16* ZC, bf16* Y, LAS unsigned char* lds, int vcu, int G, int gw, int NGW, int wave) {
    const int lane = lane_id_();
    const float* stp = a.in[opq(4)] + (size_t)l * 128 * 15 * 512; const float* sts = a.in[opq(5)] + (size_t)l * 128 * 2 * 512; const float* stc = a.in[opq(6)] + (size_t)l * 128 * 30 * 512;
    {
        const int c = wave * 64 + lane_id_();
        LAS float* red = (LAS float*)(lds + RING_OFF);
        float wc[31];
#pragma unroll
        for (int k = 0; k < 31; ++k) wc[k] = a.in[opq(19)][(size_t)l * 31 * 512 + k * 512 + c];
        const float cbias = a.in[opq(20)][l * 512 + c], lg = a.in[opq(21)][l * 512 + c], lb = a.in[opq(22)][l * 512 + c];
        const float w0 = a.in[opq(17)][(size_t)l * 3 * 512 + c], w1 = a.in[opq(17)][(size_t)l * 3 * 512 + 512 + c], w2 = a.in[opq(17)][(size_t)l * 3 * 512 + 1024 + c];
        const int pw = 2 << (wave >> 1);
        int par = 0;
        for (int item = vcu; item < 512; item += G) {
            const bool sample = item >= 256; const int q = item & 255;
            const int s = sample ? (q >> 1) : 0, rowbase = sample ? TP + s * 8 : (q >> 5) * 2048, t0 = sample ? (q & 1) * 4 : (q & 31) * 64, nbatch = sample ? 1 : 16;
            const float* sp = stp + (size_t)s * 15 * 512; const float* ss = sts + (size_t)s * 2 * 512; const float* sc = stc + (size_t)s * 30 * 512;
            float gwin[31], awin[16], xm1, xm2;
#pragma unroll
            for (int k = 0; k < 30; ++k) gwin[k + 1] = ldz(ZC, rowbase, t0 - 30 + k, 1536, sample, sc, 30, c);
#pragma unroll
            for (int k = 0; k < 15; ++k) awin[k + 1] = ldz(ZC, rowbase, t0 - 15 + k, 0, sample, sp, 15, c);
            xm2 = ldz(ZC, rowbase, t0 - 2, 512, sample, ss, 2, c); xm1 = ldz(ZC, rowbase, t0 - 1, 512, sample, ss, 2, c);
            float ng[4], na[4], nx[4], nb[4];
#pragma unroll
            for (int r = 0; r < 4; ++r) { const bf16* zr = ZC + (size_t)(rowbase + t0 + r) * 2048 + c;
                na[r] = __builtin_bit_cast(float, (unsigned)zr[0] << 16); nx[r] = __builtin_bit_cast(float, (unsigned)zr[512] << 16); nb[r] = __builtin_bit_cast(float, (unsigned)zr[1024] << 16); ng[r] = __builtin_bit_cast(float, (unsigned)zr[1536] << 16); }
            for (int b = 0; b < nbatch; ++b) {
                float cg_[4], ca_[4], cx_[4], cb_[4];
#pragma unroll
                for (int r = 0; r < 4; ++r) { cg_[r] = ng[r]; ca_[r] = na[r]; cx_[r] = nx[r]; cb_[r] = nb[r]; }
                if (b + 1 < nbatch) {
#pragma unroll
                    for (int r = 0; r < 4; ++r) { const bf16* zr = ZC + (size_t)(rowbase + t0 + 4 * (b + 1) + r) * 2048 + c;
                        na[r] = __builtin_bit_cast(float, (unsigned)zr[0] << 16); nx[r] = __builtin_bit_cast(float, (unsigned)zr[512] << 16); nb[r] = __builtin_bit_cast(float, (unsigned)zr[1024] << 16); ng[r] = __builtin_bit_cast(float, (unsigned)zr[1536] << 16); }
                }
                float cc[4];
#pragma unroll
                for (int r = 0; r < 4; ++r) {
                    const int t = t0 + 4 * b + r; bf16* yr = Y + (size_t)(rowbase + t) * 1536 + c;
#pragma unroll
                    for (int k = 0; k < 30; ++k) gwin[k] = gwin[k + 1];
                    gwin[30] = cg_[r];
                    float acc0 = cbias, acc1 = 0.f;
#pragma unroll
                    for (int k = 0; k < 30; k += 2) { acc0 += wc[k] * gwin[k]; acc1 += wc[k + 1] * gwin[k + 1]; }
                    acc0 += wc[30] * gwin[30];
                    cc[r] = acc0 + acc1;
#pragma unroll
                    for (int k = 0; k < 15; ++k) awin[k] = awin[k + 1];
                    awin[15] = ca_[r];
                    float sacc = 0.f;
#pragma unroll
                    for (int i = 0; i < 16; ++i) if (i < pw) sacc += awin[15 - i];
                    const int cnt = sample ? pw : (pw < t + 1 ? pw : t + 1);
                    st_bf(yr, sacc * (1.f / (float)cnt) - ca_[r]);
                    const float cv = w0 * xm2 + w1 * xm1 + w2 * cx_[r];
                    xm2 = xm1; xm1 = cx_[r];
                    st_bf(yr + 512, cb_[r] * cv);
                }
                float rs[8];
#pragma unroll
                for (int r = 0; r < 4; ++r) { rs[r] = wave_sum(cc[r]); rs[4 + r] = wave_sum(cc[r] * cc[r]); }
                if (lane == 0) {
#pragma unroll
                    for (int r = 0; r < 8; ++r) red[(par * 8 + wave) * 8 + r] = rs[r]; }
                __syncthreads();
                float tot[8];
#pragma unroll
                for (int r = 0; r < 8; ++r) tot[r] = 0.f;
#pragma unroll
                for (int wv = 0; wv < 8; ++wv) {
#pragma unroll
                    for (int r = 0; r < 8; ++r) tot[r] += red[(par * 8 + wv) * 8 + r]; }
                par ^= 1;
#pragma unroll
                for (int r = 0; r < 4; ++r) {
                    const float mean = tot[r] * (1.f / 512.f), var = tot[4 + r] * (1.f / 512.f) - mean * mean;
                    const float y = (cc[r] - mean) * __builtin_amdgcn_rsqf(var + EPS) * lg + lb;
                    st_bf(Y + (size_t)(rowbase + t0 + 4 * b + r) * 1536 + 1024 + c, y * pg8::sigmoidf_(y));
                }
            }
        }
    }
    const int c0 = lane * 8;
    float* out = a.out;
    for (int it = gw; it < 6392; it += NGW) {
        const bf16* zsrc = nullptr; const float* fsrc = nullptr; float* dst;
        if (it < 120) { const int b = it / 15, i = it % 15; zsrc = ZC + (size_t)(b * 2048 + 2033 + i) * 2048; dst = out + O_PP + ((size_t)(l * 8 + b) * 15 + i) * 512; }
        else if (it < 136) { const int q = it - 120, b = q / 2, i = q % 2; zsrc = ZC + (size_t)(b * 2048 + 2046 + i) * 2048 + 512; dst = out + O_SP + ((size_t)(l * 8 + b) * 2 + i) * 512; }
        else if (it < 376) { const int q = it - 136, b = q / 30, i = q % 30; zsrc = ZC + (size_t)(b * 2048 + 2018 + i) * 2048 + 1536; dst = out + O_CP + ((size_t)(l * 8 + b) * 30 + i) * 512; }
        else if (it < 2296) { const int q = it - 376, s = q / 15, i = q % 15; dst = out + O_PS + ((size_t)(l * 128 + s) * 15 + i) * 512;
            if (i < 7) fsrc = stp + ((size_t)s * 15 + 8 + i) * 512; else zsrc = ZC + (size_t)(TP + s * 8 + (i - 7)) * 2048; }
        else if (it < 2552) { const int q = it - 2296, s = q / 2, i = q % 2; zsrc = ZC + (size_t)(TP + s * 8 + 6 + i) * 2048 + 512; dst = out + O_SS + ((size_t)(l * 128 + s) * 2 + i) * 512; }
        else { const int q = it - 2552, s = q / 30, i = q % 30; dst = out + O_CS + ((size_t)(l * 128 + s) * 30 + i) * 512;
            if (i < 22) fsrc = stc + ((size_t)s * 30 + 8 + i) * 512; else zsrc = ZC + (size_t)(TP + s * 8 + (i - 22)) * 2048 + 1536; }
        const f8 v = zsrc ? ld_bf8(zsrc + c0) : ld_f8(fsrc + c0);
        *(f32x4*)(dst + c0) = v.lo; *(f32x4*)(dst + c0 + 4) = v.hi;
    }
}

constexpr int PH_PER_LAYER = 13, N_PHASES = 1 + DEPTH * PH_PER_LAYER;
__global__ void __launch_bounds__(NWAVES * 64, 2) trunk_fwd(Args args) {
    extern __shared__ __attribute__((aligned(16))) unsigned char lds_raw[];
    LAS unsigned char* lds = (LAS unsigned char*)lds_raw;
    volatile LAS unsigned* MISC = (volatile LAS unsigned*)(lds + MISC_OFF);
    const int tid0 = threadIdx.x, wave0 = __builtin_amdgcn_readfirstlane(tid0 >> 6);
    for (int u = tid0; u < (LDS_BYTES - LDSCTL_OFF) / 4; u += NWAVES * 64) ((LAS unsigned*)(lds + LDSCTL_OFF))[u] = 0u;
    __syncthreads();
    if (MK_SINGLE) (void)xcd_barrier_post((unsigned*)(ld_ws(args) + WS_CTL) + CW_BAR, MISC + 8);

    for (int ph = args.ph_lo; ph < ld_hi(args); ++ph) {
        unsigned char* ws = ld_ws(args);
        const int wave = opq(wave0);
        const int G = gridDim.x, bx = opq((int)blockIdx.x), vcu = (G % 8 == 0) ? (bx % 8) * (G / 8) + bx / 8 : bx;
        const int gw = vcu * NWAVES + wave, NGW = G * NWAVES;
        bf16* U = (bf16*)(ws + WS_U); bf16* ZC = (bf16*)(ws + WS_ZC); bf16* SG = (bf16*)(ws + WS_SG); bf16* ACT = (bf16*)(ws + WS_SG); bf16* Y = (bf16*)(ws + WS_Y); bf16* PPb = (bf16*)(ws + WS_Y);
        float* Fb = (float*)(ws + WS_ZC); bf16* P16 = (bf16*)(ws + WS_P16);
        if (ph >= 100) {
            const int which = ph - 100; const bf16* src = which == 0 ? Y : which == 1 ? Y + 512 : which == 2 ? U : which == 3 ? PPb : which == 4 ? ZC : which == 5 ? SG : which == 6 ? SG + 2048 : ZC + (size_t)17408 * 1024; const int stride = which <= 1 ? 1536 : (which == 4 ? 2048 : (which == 5 || which == 6) ? 3072 : 1024);
            for (size_t i = (size_t)gw * 64 + lane_id_(); i < (size_t)T * 1024; i += (size_t)NGW * 64) { const size_t r = i >> 10, c = i & 1023; args.out[i] = __builtin_bit_cast(float, (unsigned)src[r * stride + c] << 16); }
        } else
        if (ph == 0) {
            prep_phase(args, 0, lds, gw, NGW, wave);
            row_pass<0>(args, nullptr, 0.f, nullptr, args.in[opq(7)], U, gw, NGW);
        } else {
            const int l = (ph - 1) / PH_PER_LAYER, k = (ph - 1) % PH_PER_LAYER;
            if (k == 0 || k == 8) {
                pg8::Gemm g{U, (const bf16*)(ws + (k == 0 ? WS_WGU1 : WS_WGU2)), D, D, D, 0, 0}; pg8::StaticOrder S; S.init(T, 2 * FF, 1, G, opq(bx));
                pg8::EpiSwiglu E{ACT, FF};
                pg8::gemm_phase<pg8::EpiSwiglu, pg8::StaticOrder, true, true>(lds + RING_OFF, g, S, E, wave);
            } else if (k == 1 || k == 9) {
                pg8::Gemm g{ACT, (const bf16*)(ws + (k == 1 ? WS_WD1 : WS_WD2)), FF, FF, FF, 0, 0}; pg8::StaticOrder S; S.init(T, D, 1, G, opq(bx));
                pg8::EpiF32 E{Fb, D};
                pg8::gemm_phase<pg8::EpiF32, pg8::StaticOrder, true, true>(lds + RING_OFF, g, S, E, wave);
            } else if (k == 2) {
                row_pass<1>(args, Fb, 0.5f, args.in[opq(11)] + l * D, args.in[opq(12)] + l * D, U, gw, NGW);
            } else if (k == 3) {
                pg8::Gemm g{U, (const bf16*)(ws + WS_WIN), D, D, D, 0, 0}; pg8::StaticOrder S; S.init(T, NIN, 1, G, opq(bx));
                pg8::EpiZ E{ZC, SG};
                pg8::gemm_phase<pg8::EpiZ, pg8::StaticOrder, true, true>(lds + RING_OFF, g, S, E, wave);
            } else if (k == 4) {
                conv_phase(args, l, ZC, Y, lds, vcu, G, gw, NGW, wave);
            } else if (k == 5) {
                pg8::Gemm g{Y, (const bf16*)(ws + WS_WBR), 1536, 512, 512, 512 * 2, D * 512 * 2}; pg8::StaticOrder S; S.init(T, D, 3, G, opq(bx));
                pg8::EpiBranch E{SG, ZC, U};
                pg8::gemm_phase<pg8::EpiBranch, pg8::StaticOrder, true, true>(lds + RING_OFF, g, S, E, wave);
            } else if (k == 6) {
                pg8::Gemm g{U, (const bf16*)(ws + WS_WO), D, D, D, 0, 0}; pg8::StaticOrder S; S.init(T, D, 1, G, opq(bx));
                pg8::EpiF32 E{Fb, D};
                pg8::gemm_phase<pg8::EpiF32, pg8::StaticOrder, true, true>(lds + RING_OFF, g, S, E, wave);
            } else if (k == 7) {
                { pg8::Gemm g{P16, (const bf16*)(ws + WS_WPP), PLE, PLE, PLE, 0, 0}; pg8::StaticOrder S; S.init(T, D, 1, G, opq(bx));
                  pg8::EpiBf16 E{PPb, D};
                  pg8::gemm_phase<pg8::EpiBf16, pg8::StaticOrder, true, true>(lds + RING_OFF, g, S, E, wave); }
                row_pass<1>(args, Fb, 1.0f, args.in[opq(25)] + l * D, args.in[opq(26)] + l * D, U, gw, NGW);
            } else if (k == 10) {
                row_pass<1>(args, Fb, 0.5f, args.in[opq(30)] + l * D, args.in[opq(31)] + l * D, U, gw, NGW);
            } else if (k == 11) {
                pg8::Gemm g{U, (const bf16*)(ws + WS_WPG), D, D, D, 0, 0}; pg8::StaticOrder S; S.init(T, D, 1, G, opq(bx));
                pg8::EpiPle E{PPb, Fb};
                pg8::gemm_phase<pg8::EpiPle, pg8::StaticOrder, true, true>(lds + RING_OFF, g, S, E, wave);
            } else {
                if (l + 1 < DEPTH) { row_pass<1>(args, Fb, 1.0f, args.in[opq(34)] + l * D, args.in[opq(7)] + (l + 1) * D, U, gw, NGW); prep_phase(args, l + 1, lds, gw, NGW, wave); }
                else row_pass<2>(args, Fb, 1.0f, args.in[opq(34)] + l * D, args.in[opq(35)], U, gw, NGW);
            }
        }
        if (MK_SINGLE) { if (ph + 1 < ld_hi(args)) { XcdBarrier bar; bar.bar = (unsigned*)(ld_ws(args) + WS_CTL) + CW_BAR; bar.x = xb_xcc_id(); bar.st = MISC + 8; xcd_barrier(bar); } }
    }
}

extern "C" void kernel_launch(void* const* d_in, const int* in_sizes, int n_in, void* d_out, int out_size, void* d_ws, size_t ws_size, hipStream_t stream) {
    static int grid = 0;
    if (grid == 0) {
        if (n_in != 36 || (size_t)out_size != O_END || ws_size < WS_END) { fprintf(stderr, "kernel_launch: unexpected shapes: n_in %d out %d ws %zu (need %zu); nothing launched\n", n_in, out_size, ws_size, (size_t)WS_END); grid = -1; return; }
        int dev = 0, cus = 0, per_cu = 0;
        if (hipGetDevice(&dev) != hipSuccess || hipDeviceGetAttribute(&cus, hipDeviceAttributeMultiprocessorCount, dev) != hipSuccess) { grid = -1; return; }
        if (hipFuncSetAttribute((const void*)trunk_fwd, hipFuncAttributeMaxDynamicSharedMemorySize, LDS_BYTES) != hipSuccess) { fprintf(stderr, "kernel_launch: hipFuncSetAttribute failed\n"); grid = -1; return; }
        if (hipOccupancyMaxActiveBlocksPerMultiprocessor(&per_cu, (const void*)trunk_fwd, NWAVES * 64, LDS_BYTES) != hipSuccess || per_cu < 1) { fprintf(stderr, "kernel_launch: occupancy query says %d\n", per_cu); }
        (void)hipGetLastError();
        grid = cus;
    }
    if (grid < 0) return;
    (void)hipMemsetAsync((char*)d_ws + WS_CTL, 0, CTL_ZERO_BYTES, stream);
    Args a{};
    for (int i = 0; i < 36; ++i) a.in[i] = (const float*)d_in[i];
    a.out = (float*)d_out; a.ws = (unsigned char*)d_ws;
#if MK_SINGLE
    a.ph_lo = 0; a.ph_hi = N_PHASES;
    hipLaunchKernelGGL(trunk_fwd, dim3(grid), dim3(NWAVES * 64), LDS_BYTES, stream, a);
#else
#ifndef DBG_STOP
#define DBG_STOP N_PHASES
#endif
    for (int ph = 0; ph < DBG_STOP; ++ph) { a.ph_lo = ph; a.ph_hi = ph + 1; hipLaunchKernelGGL(trunk_fwd, dim3(grid), dim3(NWAVES * 64), LDS_BYTES, stream, a); }
#ifdef DBG_DUMP
    a.ph_lo = 100 + DBG_DUMP; a.ph_hi = a.ph_lo + 1; hipLaunchKernelGGL(trunk_fwd, dim3(grid), dim3(NWAVES * 64), LDS_BYTES, stream, a);
#endif
#endif
}
```
